# Optimizing an MI355X kernel written in HIP

```python
import math
import jax, jax.numpy as jnp
from jax import lax
import numpy as np

D_MODEL = 1024
BATCH = 1
SEQ = 16384
DEPTH = 1
DEC_BATCH = 128
DEC_SEQ = 1
PAST_LEN = 16384
PAGE_SIZE = 128

N_HEADS = 8
N_KV_HEADS = 2
HEAD_DIM = 64
GROUP = N_HEADS // N_KV_HEADS
ATTN_W = N_HEADS * HEAD_DIM
KV_W = N_KV_HEADS * HEAD_DIM
CONV_CH = D_MODEL - ATTN_W
MIX_W = ATTN_W + CONV_CH
IN_W = ATTN_W + 2 * KV_W + 2 * CONV_CH
CONV_WIDTH = 31
WINDOW = 128
BLOCK = 128
N_BUCKETS = 32
MAX_DISTANCE = WINDOW
N_META = 16
D_FF = 4 * D_MODEL
EPS = 1e-6

kernel_name = "hymba_swa_sink_conformer_conv_decoder_step"


def rmsnorm(x, g):
    xf = x.astype(jnp.float32)
    y = xf * lax.rsqrt(jnp.mean(xf * xf, axis=-1, keepdims=True) + EPS)
    return (y * g.astype(jnp.float32)).astype(x.dtype)


def layernorm(x, g, b):
    xf = x.astype(jnp.float32)
    mu = jnp.mean(xf, axis=-1, keepdims=True)
    xc = xf - mu
    y = xc * lax.rsqrt(jnp.mean(xc * xc, axis=-1, keepdims=True) + EPS)
    return (y * g.astype(jnp.float32) + b.astype(jnp.float32)).astype(x.dtype)


def t5_bucket(d):
    max_exact = N_BUCKETS // 2
    d_f = jnp.maximum(d, 1).astype(jnp.float32)
    large = max_exact + (jnp.log(d_f / max_exact) / math.log(MAX_DISTANCE / max_exact)
                         * (N_BUCKETS - max_exact)).astype(jnp.int32)
    large = jnp.minimum(large, N_BUCKETS - 1)
    return jnp.where(d < max_exact, d, large)


def sink_attention(q, k, v, dist, valid, rel_bias, sinks):
    q = q.reshape(q.shape[:-2] + (N_KV_HEADS, GROUP, HEAD_DIM))
    s = jnp.einsum('...qhgd,...khd->...hgqk', q, k,
                   preferred_element_type=jnp.float32) * (HEAD_DIM ** -0.5)
    bias = rel_bias.astype(jnp.float32)[t5_bucket(jnp.clip(dist, 0, WINDOW))]
    bias = jnp.moveaxis(bias, -1, 0).reshape((N_KV_HEADS, GROUP) + dist.shape)
    s = jnp.where(valid, s + bias, -jnp.inf)
    sk = sinks.astype(jnp.float32).reshape(N_KV_HEADS, GROUP, 1, 1)
    m = jnp.maximum(jnp.max(s, axis=-1, keepdims=True), sk)
    p = jnp.exp(s - m)
    p = p / (jnp.sum(p, axis=-1, keepdims=True) + jnp.exp(sk - m))
    o = jnp.einsum('...hgqk,...khd->...qhgd', p.astype(v.dtype), v)
    return o.reshape(o.shape[:-3] + (ATTN_W,))


def project_in(x, norm1_g, w_in):
    h = rmsnorm(x, norm1_g)
    p = h @ w_in
    lead = p.shape[:-1]
    o1, o2, o3, o4 = ATTN_W, ATTN_W + KV_W, ATTN_W + 2 * KV_W, ATTN_W + 2 * KV_W + CONV_CH
    q = p[..., :o1].reshape(lead + (N_HEADS, HEAD_DIM))
    k = p[..., o1:o2].reshape(lead + (N_KV_HEADS, HEAD_DIM))
    v = p[..., o2:o3].reshape(lead + (N_KV_HEADS, HEAD_DIM))
    u = p[..., o3:o4] * jax.nn.sigmoid(p[..., o4:])
    return q, k, v, u


def depthwise_conv(u_padded, conv_w, conv_b):
    out = lax.conv_general_dilated(u_padded, conv_w[:, None, :].astype(u_padded.dtype),
                                   window_strides=(1,), padding='VALID',
                                   dimension_numbers=('NWC', 'WIO', 'NWC'),
                                   feature_group_count=CONV_CH)
    return out + conv_b


def finish_layer(x, attn_o, conv_c, conv_ln_g, conv_ln_b, w_out, norm2_g, w_up, w_down):
    c = jax.nn.silu(layernorm(conv_c, conv_ln_g, conv_ln_b))
    x = x + jnp.concatenate([attn_o.astype(x.dtype), c.astype(x.dtype)], axis=-1) @ w_out
    hid = jnp.square(jax.nn.relu(rmsnorm(x, norm2_g) @ w_up))
    return x + hid @ w_down


def setup_inputs(seed: int = 0) -> dict:
    key = jax.random.key(seed)
    ks = jax.random.split(key, 20)
    f = jnp.float32
    nrm = lambda k, shape, sc: jax.random.normal(k, shape, f) * sc
    return {
        'x_prompt': nrm(ks[0], (BATCH, SEQ, D_MODEL), 1.0),
        'x_sample': nrm(ks[1], (DEC_BATCH, DEC_SEQ, D_MODEL), 1.0),
        'cache_k': nrm(ks[2], (DEPTH, DEC_BATCH, WINDOW, N_KV_HEADS, HEAD_DIM), 1.0),
        'cache_v': nrm(ks[3], (DEPTH, DEC_BATCH, WINDOW, N_KV_HEADS, HEAD_DIM), 1.0),
        'state_conv': nrm(ks[4], (DEPTH, DEC_BATCH, CONV_WIDTH - 1, CONV_CH), 0.5),
        'meta_tokens': nrm(ks[5], (N_META, D_MODEL), 1.0),
        'rel_bias': nrm(ks[6], (N_BUCKETS, N_HEADS), 0.5),
        'norm1_g': 1.0 + nrm(ks[7], (DEPTH, D_MODEL), 0.02),
        'w_in': nrm(ks[8], (DEPTH, D_MODEL, IN_W), D_MODEL ** -0.5),
        'attn_sinks': nrm(ks[9], (DEPTH, N_HEADS), 0.5),
        'conv_w': nrm(ks[10], (DEPTH, CONV_WIDTH, CONV_CH), CONV_WIDTH ** -0.5),
        'conv_b': nrm(ks[11], (DEPTH, CONV_CH), 0.02),
        'conv_ln_g': 1.0 + nrm(ks[12], (DEPTH, CONV_CH), 0.02),
        'conv_ln_b': nrm(ks[13], (DEPTH, CONV_CH), 0.02),
        'w_out': nrm(ks[14], (DEPTH, MIX_W, D_MODEL), MIX_W ** -0.5),
        'norm2_g': 1.0 + nrm(ks[15], (DEPTH, D_MODEL), 0.02),
        'w_up': nrm(ks[16], (DEPTH, D_MODEL, D_FF), D_MODEL ** -0.5),
        'w_down': nrm(ks[17], (DEPTH, D_FF, D_MODEL), D_FF ** -0.5),
        'norm_f_g': 1.0 + nrm(ks[18], (D_MODEL,), 0.02),
    }


def reference(x_prompt, x_sample, cache_k, cache_v, state_conv, meta_tokens, rel_bias,
              norm1_g, w_in, attn_sinks, conv_w, conv_b, conv_ln_g, conv_ln_b,
              w_out, norm2_g, w_up, w_down, norm_f_g):
    B, S_p, _ = x_prompt.shape
    DB, S_s, _ = x_sample.shape
    xp = jnp.concatenate([jnp.broadcast_to(meta_tokens[None].astype(x_prompt.dtype), (B, N_META, D_MODEL)),
                          x_prompt], axis=1)
    L = S_p + N_META
    pad = (-N_META) % BLOCK
    Lp = L + pad
    nblk = Lp // BLOCK
    bi = jnp.arange(BLOCK)[:, None]
    bj = jnp.arange(2 * BLOCK)[None, :]
    dist_p = bi + BLOCK - bj
    key_idx = (jnp.arange(nblk)[:, None] - 1) * BLOCK + jnp.arange(2 * BLOCK)[None, :]
    valid_p = ((dist_p >= 0) & (dist_p <= WINDOW))[None] & (key_idx >= pad)[:, None, :]
    valid_p = valid_p[:, None, None]
    qi = jnp.arange(S_s)[:, None]
    kj = jnp.arange(WINDOW + S_s)[None, :]
    dist_s = qi + WINDOW - kj
    valid_s = ((dist_s >= 0) & (dist_s <= WINDOW))[None, None, None]

    def blocks(t):
        t = jnp.pad(t, ((0, 0), (pad, 0)) + ((0, 0),) * (t.ndim - 2))
        return t.reshape((B, nblk, BLOCK) + t.shape[2:])

    def with_prev(tb):
        prev = jnp.pad(tb, ((0, 0), (1, 0)) + ((0, 0),) * (tb.ndim - 2))[:, :-1]
        return jnp.concatenate([prev, tb], axis=2)

    xs = x_sample
    nk_p, nv_p, nc_p, nk_s, nv_s, nc_s = [], [], [], [], [], []
    for l in range(DEPTH):
        q, k, v, u = project_in(xp, norm1_g[l], w_in[l])
        ao = sink_attention(blocks(q), with_prev(blocks(k)), with_prev(blocks(v)),
                            dist_p, valid_p, rel_bias, attn_sinks[l])
        ao = ao.reshape(B, Lp, ATTN_W)[:, pad:]
        cc = depthwise_conv(jnp.pad(u, ((0, 0), (CONV_WIDTH - 1, 0), (0, 0))), conv_w[l], conv_b[l])
        xp = finish_layer(xp, ao, cc, conv_ln_g[l], conv_ln_b[l], w_out[l], norm2_g[l], w_up[l], w_down[l])
        nk_p.append(k[:, -WINDOW:])
        nv_p.append(v[:, -WINDOW:])
        nc_p.append(u[:, -(CONV_WIDTH - 1):])
        q, k, v, u = project_in(xs, norm1_g[l], w_in[l])
        kk = jnp.concatenate([cache_k[l].astype(k.dtype), k], axis=1)
        vv = jnp.concatenate([cache_v[l].astype(v.dtype), v], axis=1)
        ao = sink_attention(q, kk, vv, dist_s, valid_s, rel_bias, attn_sinks[l])
        uu = jnp.concatenate([state_conv[l].astype(u.dtype), u], axis=1)
        cc = depthwise_conv(uu, conv_w[l], conv_b[l])
        xs = finish_layer(xs, ao, cc, conv_ln_g[l], conv_ln_b[l], w_out[l], norm2_g[l], w_up[l], w_down[l])
        nk_s.append(kk[:, -WINDOW:])
        nv_s.append(vv[:, -WINDOW:])
        nc_s.append(uu[:, -(CONV_WIDTH - 1):])

    y_prompt = rmsnorm(xp, norm_f_g)[:, N_META:]
    y_sample = rmsnorm(xs, norm_f_g)
    return (y_prompt, y_sample, jnp.stack(nk_p), jnp.stack(nv_p), jnp.stack(nc_p),
            jnp.stack(nk_s), jnp.stack(nv_s), jnp.stack(nc_s))
```

```cpp
#include <hip/hip_runtime.h>
#include <cstdio>
#include <cstdint>
namespace pg8 {
#define PG8_LAS __attribute__((address_space(3)))
typedef unsigned short bf16_t;
typedef short bf16x8 __attribute__((ext_vector_type(8)));
typedef float f32x4 __attribute__((ext_vector_type(4)));
typedef unsigned u32x4 __attribute__((ext_vector_type(4)));
constexpr int BM = 256, BK = 64, HALF = 128, HTB = HALF * BK * 2  , STAGE_BYTES = 8 * HTB, NXCD = 8, WGM = 8;

__host__ __device__ __forceinline__ int lds_byte(int r, int c) { const int st = (r >> 4) * 2 + (c >> 5), rr = r & 15, cc = c & 31, ob = rr * 64 + cc * 2; return st * 1024 + (ob ^ (((ob >> 9) & 1) << 5)); }
__host__ __device__ __forceinline__ void stage_rc(int b, int& R, int& C) { const int st = b / 1024, sb = b % 1024, swz = sb ^ (((sb >> 9) & 1) << 5); R = (st >> 1) * 16 + swz / 64; C = (st & 1) * 32 + (swz % 64) / 2; }
__host__ __device__ __forceinline__ int perm32(int rho) { const int n = rho >> 4, i = rho & 15; return 8 * (i >> 2) + 4 * n + (i & 3); }

struct Unit { int pm, pn; };
struct Gemm { const bf16_t* A; const bf16_t* Bt; int M, N, K; };

struct StaticOrder {
    int nM, nN, nwg, G, c;
    __host__ __device__ void init(int M, int N, int G_, int c_) { nM = M / BM; nN = N / BM; nwg = nM * nN; G = G_; c = c_; }
    __host__ __device__ bool next(int i, Unit& u) const {
        const long L = (long)i * G + c; if (L >= nwg) return false;
        int wgid = (int)L; { const int q = nwg / NXCD, r = nwg % NXCD, xcd = wgid % NXCD, off = wgid / NXCD; wgid = (xcd < r ? xcd * (q + 1) : r * (q + 1) + (xcd - r) * q) + off; }
        const int nig = WGM * nN, gid = wgid / nig, fm = gid * WGM, gsz = (nM - fm) < WGM ? (nM - fm) : WGM;
        u.pm = fm + ((wgid % nig) % gsz); u.pn = (wgid % nig) / gsz; return true;
    }
    __device__ __forceinline__ void a_ready(const Unit&) const {}
    __device__ __forceinline__ void done(const Unit&) const {}
};

__device__ __forceinline__ unsigned cvt_pk_bf16(float lo, float hi) { unsigned r; asm volatile("v_cvt_pk_bf16_f32 %0, %1, %2" : "=v"(r) : "v"(lo), "v"(hi)); return r; }
typedef unsigned u32x2 __attribute__((ext_vector_type(2)));

constexpr int R_SAMPLE = 16384, R_META = 16512, R_PADROW = 16528, M_PAD = 16640;
constexpr size_t OFF_YS = 16777216, OFF_NKP = 16908288, OFF_NVP = 16924672, OFF_NCP = 16941056, OFF_NKS = 16956416, OFF_NVS = 19053568, OFF_NCS = 21150720;

__device__ __forceinline__ u32x4 pack8(const f32x4& a, const f32x4& b) { u32x4 w; w.x = cvt_pk_bf16(a[0], a[1]); w.y = cvt_pk_bf16(a[2], a[3]); w.z = cvt_pk_bf16(b[0], b[1]); w.w = cvt_pk_bf16(b[2], b[3]); return w; }

struct EpiQKV {
    static constexpr bool PERM = true, AFTER_DRAIN = false;
    bf16_t *Q, *Kb, *Vb, *U; float* out;
    __device__ __forceinline__ void operator()(const f32x4 (&acc)[2][2][4][2], const Unit& u, int wr, int wc, int fr, int fq) const {
        const int cl = wc * 32 + 8 * fq, pn = u.pn;
        if (pn < 2) {
#pragma unroll
            for (int ai = 0; ai < 2; ++ai)
#pragma unroll
                for (int m = 0; m < 4; ++m) { const size_t R = (size_t)(u.pm * BM + ai * HALF + wr * 64 + m * 16 + fr);
#pragma unroll
                    for (int bj = 0; bj < 2; ++bj) *(u32x4*)(Q + R * 512 + pn * 256 + bj * HALF + cl) = pack8(acc[ai][bj][m][0] * 0.125f, acc[ai][bj][m][1] * 0.125f); }
        } else if (pn == 2) {
#pragma unroll
            for (int ai = 0; ai < 2; ++ai)
#pragma unroll
                for (int m = 0; m < 4; ++m) { const int R = u.pm * BM + ai * HALF + wr * 64 + m * 16 + fr;
                    *(u32x4*)(Kb + (size_t)R * 128 + cl) = pack8(acc[ai][0][m][0], acc[ai][0][m][1]);
                    *(u32x4*)(Vb + (size_t)R * 128 + cl) = pack8(acc[ai][1][m][0], acc[ai][1][m][1]);
                    if (u.pm >= 63) {
                        float *pk = nullptr, *pv = nullptr;
                        if (R >= 16256 && R < R_SAMPLE) { pk = out + OFF_NKP + (size_t)(R - 16256) * 128 + cl; pv = out + OFF_NVP + (size_t)(R - 16256) * 128 + cl; }
                        else if (R >= R_SAMPLE && R < R_META) { const size_t o = ((size_t)(R - R_SAMPLE) * 128 + 127) * 128 + cl; pk = out + OFF_NKS + o; pv = out + OFF_NVS + o; }
                        if (pk) { *(f32x4*)pk = acc[ai][0][m][0]; *(f32x4*)(pk + 4) = acc[ai][0][m][1]; *(f32x4*)pv = acc[ai][1][m][0]; *(f32x4*)(pv + 4) = acc[ai][1][m][1]; }
                    } }
        } else {
            const int ch0 = (pn - 3) * 128 + cl;
#pragma unroll
            for (int ai = 0; ai < 2; ++ai)
#pragma unroll
                for (int m = 0; m < 4; ++m) { const int R = u.pm * BM + ai * HALF + wr * 64 + m * 16 + fr;
                    f32x4 g[2];
#pragma unroll
                    for (int n = 0; n < 2; ++n)
#pragma unroll
                        for (int i = 0; i < 4; ++i) { const float a = acc[ai][0][m][n][i], b = acc[ai][1][m][n][i]; g[n][i] = a * __builtin_amdgcn_rcpf(1.0f + __expf(-b)); }
                    *(u32x4*)(U + (size_t)R * 512 + ch0) = pack8(g[0], g[1]);
                    if (u.pm >= 63) {
                        float* pc = nullptr;
                        if (R >= 16354 && R < R_SAMPLE) pc = out + OFF_NCP + (size_t)(R - 16354) * 512 + ch0;
                        else if (R >= R_SAMPLE && R < R_META) pc = out + OFF_NCS + ((size_t)(R - R_SAMPLE) * 30 + 29) * 512 + ch0;
                        if (pc) { *(f32x4*)pc = g[0]; *(f32x4*)(pc + 4) = g[1]; }
                    } }
        }
    }
};

struct ResPtrs { const float *xp, *xs; float *xrem, *out; };
__device__ __forceinline__ void res_half(const ResPtrs& P, int Rb, const float*& src, float*& dst) {
    if (Rb < R_SAMPLE) { src = P.xp + (size_t)Rb * 1024; dst = P.out + (size_t)Rb * 1024; }
    else if (Rb < R_META) { src = P.xs + (size_t)(Rb - R_SAMPLE) * 1024; dst = P.out + (size_t)Rb * 1024; }
    else { src = P.xrem + (size_t)(Rb - R_META) * 1024; dst = P.xrem + (size_t)(Rb - R_META) * 1024; }
}

struct EpiWo {
    static constexpr bool PERM = false, AFTER_DRAIN = false;
    ResPtrs P; bf16_t* xn; float* ss;
    __device__ __forceinline__ void operator()(const f32x4 (&acc)[2][2][4][2], const Unit& u, int wr, int wc, int fr, int fq) const {
        const int col0 = u.pn * BM + wc * 32 + 4 * fq;
#pragma unroll
        for (int ai = 0; ai < 2; ++ai) {
            const int Rb = u.pm * BM + ai * HALF; const float* src; float* dst; res_half(P, Rb, src, dst);
#pragma unroll
            for (int m = 0; m < 4; ++m) { const int rl = wr * 64 + m * 16 + fr; float s = 0.f;
#pragma unroll
                for (int bj = 0; bj < 2; ++bj)
#pragma unroll
                    for (int n = 0; n < 2; ++n) { const int c = col0 + bj * HALF + n * 16;
                        const f32x4 x1 = acc[ai][bj][m][n] + *(const f32x4*)(src + (size_t)rl * 1024 + c);
                        *(f32x4*)(dst + (size_t)rl * 1024 + c) = x1;
                        u32x2 w; w.x = cvt_pk_bf16(x1[0], x1[1]); w.y = cvt_pk_bf16(x1[2], x1[3]); *(u32x2*)(xn + (size_t)(Rb + rl) * 1024 + c) = w;
                        s += (x1[0] * x1[0] + x1[1] * x1[1]) + (x1[2] * x1[2] + x1[3] * x1[3]); }
                s += __shfl_xor(s, 16); s += __shfl_xor(s, 32);
                if (fq == 0) ss[(size_t)(Rb + rl) * 16 + u.pn * 4 + wc] = s;
                asm volatile("" ::: "memory"); }
        }
    }
};

struct EpiUp {
    static constexpr bool PERM = true, AFTER_DRAIN = false;
    bf16_t* H; const float* ss; float eps;
    __device__ __forceinline__ void operator()(const f32x4 (&acc)[2][2][4][2], const Unit& u, int wr, int wc, int fr, int fq) const {
        const int col0 = u.pn * BM + wc * 32 + 8 * fq;
#pragma unroll
        for (int ai = 0; ai < 2; ++ai)
#pragma unroll
            for (int m = 0; m < 4; ++m) { const size_t R = (size_t)(u.pm * BM + ai * HALF + wr * 64 + m * 16 + fr);
                const f32x4* sp = (const f32x4*)(ss + R * 16); const f32x4 t = (sp[0] + sp[1]) + (sp[2] + sp[3]);
                const float rs = 1.0f / sqrtf(((t[0] + t[1]) + (t[2] + t[3])) * (1.0f / 1024.0f) + eps);
#pragma unroll
                for (int bj = 0; bj < 2; ++bj) { f32x4 v0 = acc[ai][bj][m][0] * rs, v1 = acc[ai][bj][m][1] * rs;
#pragma unroll
                    for (int i = 0; i < 4; ++i) { const float a = fmaxf(v0[i], 0.f), b = fmaxf(v1[i], 0.f); v0[i] = a * a; v1[i] = b * b; }
                    *(u32x4*)(H + R * 4096 + col0 + bj * HALF) = pack8(v0, v1); } }
    }
};

struct EpiDown {
    static constexpr bool PERM = false, AFTER_DRAIN = false;
    ResPtrs P; float* ss;
    __device__ __forceinline__ void operator()(const f32x4 (&acc)[2][2][4][2], const Unit& u, int wr, int wc, int fr, int fq) const {
        const int col0 = u.pn * BM + wc * 32 + 4 * fq;
#pragma unroll
        for (int ai = 0; ai < 2; ++ai) {
            const int Rb = u.pm * BM + ai * HALF; const float* src; float* dst; res_half(P, Rb, src, dst);
#pragma unroll
            for (int m = 0; m < 4; ++m) { const int rl = wr * 64 + m * 16 + fr; float s = 0.f;
#pragma unroll
                for (int bj = 0; bj < 2; ++bj)
#pragma unroll
                    for (int n = 0; n < 2; ++n) { const int c = col0 + bj * HALF + n * 16;
                        const f32x4 x2 = acc[ai][bj][m][n] + *(const f32x4*)(dst + (size_t)rl * 1024 + c);
                        *(f32x4*)(dst + (size_t)rl * 1024 + c) = x2;
                        s += (x2[0] * x2[0] + x2[1] * x2[1]) + (x2[2] * x2[2] + x2[3] * x2[3]); }
                s += __shfl_xor(s, 16); s += __shfl_xor(s, 32);
                if (fq == 0) ss[(size_t)(Rb + rl) * 16 + u.pn * 4 + wc] = s;
                asm volatile("" ::: "memory"); }
        }
    }
};

template <class Epi, class Sched, bool ALIGN_EPI = false, bool SP2 = false>
__device__ __forceinline__ void gemm_phase(PG8_LAS unsigned char* lds, const Gemm g, const Sched& S, const Epi& E) {
    const int tid = threadIdx.x, wid = __builtin_amdgcn_readfirstlane(tid >> 6), lane = tid & 63, wr = wid >> 2, wc = wid & 3, fr = lane & 15, fq = lane >> 4;
    const int K = g.K, nt = K / BK;
    unsigned voffA[2], voffB[2];
#pragma unroll
    for (int i = 0; i < 2; ++i) { int R, C; stage_rc(tid * 16 + i * 8192, R, C); const int Rb = Epi::PERM ? ((R & ~31) + perm32(R & 31)) : R;
        voffA[i] = (unsigned)(R * K + C) * 2u; voffB[i] = (unsigned)(Rb * K + C) * 2u; }
    const size_t kstep = (size_t)(BK * 2);
    const size_t hstep = (size_t)HALF * K * 2;
    const size_t tstep = 2 * hstep;
    const unsigned ldsw = (unsigned)wid * 1024u;
    const int aoff = lds_byte(wr * 64 + fr, fq * 8), boff = lds_byte(wc * 32 + fr, fq * 8);
#define PG8_SA(b, h) (((b) * 2 + (h)) * HTB)
#define PG8_SB(b, h) ((4 + (b) * 2 + (h)) * HTB)
#define PG8_STAGE(bufoff, gbase, voff) do { _Pragma("unroll") for (int _i = 0; _i < 2; ++_i) \
        __builtin_amdgcn_global_load_lds((const unsigned*)((const char*)(gbase) + (voff)[_i]), (PG8_LAS unsigned*)(lds + (bufoff) + ldsw + _i * 8192), 16, 0, 0); } while (0)
#define PG8_LDA(dst, b, h) do { _Pragma("unroll") for (int m = 0; m < 4; ++m) _Pragma("unroll") for (int k = 0; k < 2; ++k) dst[m][k] = *(const PG8_LAS bf16x8*)(lds + PG8_SA(b, h) + aoff + m * 2048 + k * 1024); } while (0)
#define PG8_LDB(dst, b, h) do { _Pragma("unroll") for (int n = 0; n < 2; ++n) _Pragma("unroll") for (int k = 0; k < 2; ++k) dst[n][k] = *(const PG8_LAS bf16x8*)(lds + PG8_SB(b, h) + boff + n * 2048 + k * 1024); } while (0)
#define PG8_MMA(ai, bj, At, Bt) do { __builtin_amdgcn_s_setprio(1); _Pragma("unroll") for (int m = 0; m < 4; ++m) _Pragma("unroll") for (int n = 0; n < 2; ++n) _Pragma("unroll") for (int k = 0; k < 2; ++k) \
        acc[ai][bj][m][n] = __builtin_amdgcn_mfma_f32_16x16x32_bf16(Bt[n][k], At[m][k], acc[ai][bj][m][n], 0, 0, 0); __builtin_amdgcn_s_setprio(0); } while (0)
#define PG8_WAIT_V(n) asm volatile("s_waitcnt vmcnt(" #n ")" ::: "memory")
#define PG8_WAIT_L(n) asm volatile("s_waitcnt lgkmcnt(" #n ")" ::: "memory")
#define PG8_BAR __builtin_amdgcn_s_barrier()
#define PG8_SCHED __builtin_amdgcn_sched_barrier(0)
    Unit cur, nxt; int ui = 0;
    if (!S.next(0, cur)) return;
    f32x4 acc[2][2][4][2];
#pragma unroll
    for (int a = 0; a < 2; ++a)
#pragma unroll
        for (int b = 0; b < 2; ++b)
#pragma unroll
            for (int m = 0; m < 4; ++m)
#pragma unroll
                for (int n = 0; n < 2; ++n) acc[a][b][m][n] = (f32x4){0.f, 0.f, 0.f, 0.f};
    bf16x8 At[4][2], B0[2][2], B1[2][2];
    const char* cA = (const char*)g.A + (size_t)cur.pm * tstep; const char* cB = (const char*)g.Bt + (size_t)cur.pn * tstep;
    S.a_ready(cur);
    if constexpr (SP2) {
        PG8_STAGE(PG8_SB(0, 0), cB, voffB); PG8_STAGE(PG8_SB(0, 1), cB + hstep, voffB); PG8_STAGE(PG8_SA(0, 0), cA, voffA); PG8_STAGE(PG8_SA(0, 1), cA + hstep, voffA);
        if (wr == 1) PG8_BAR;
        PG8_WAIT_V(2); PG8_BAR;
        PG8_STAGE(PG8_SB(1, 0), cB + kstep, voffB); PG8_STAGE(PG8_SA(1, 0), cA + kstep, voffA); PG8_STAGE(PG8_SB(1, 1), cB + hstep + kstep, voffB);
        PG8_WAIT_V(6); PG8_BAR;
    } else {
        PG8_STAGE(PG8_SB(0, 0), cB, voffB); PG8_STAGE(PG8_SA(0, 0), cA, voffA); PG8_STAGE(PG8_SB(0, 1), cB + hstep, voffB); PG8_STAGE(PG8_SA(0, 1), cA + hstep, voffA);
        if (wr == 1) PG8_BAR;
        PG8_WAIT_V(4); PG8_BAR;
        PG8_STAGE(PG8_SB(1, 0), cB + kstep, voffB); PG8_STAGE(PG8_SA(1, 0), cA + kstep, voffA); PG8_STAGE(PG8_SB(1, 1), cB + hstep + kstep, voffB);
        PG8_WAIT_V(6); PG8_BAR;
    }
    for (;;) {
        const bool has_next = S.next(ui + 1, nxt);
        const char* nA = has_next ? (const char*)g.A + (size_t)nxt.pm * tstep : cA; const char* nB = has_next ? (const char*)g.Bt + (size_t)nxt.pn * tstep : cB;
        for (int t = 0; t < nt; t += 2) {
            const bool last = (t == nt - 2);
            const char* a1 = cA + (size_t)(t + 1) * kstep;
            const char* a2 = last ? nA : cA + (size_t)(t + 2) * kstep; const char* b2 = last ? nB : cB + (size_t)(t + 2) * kstep;
            const char* a3 = a2 + kstep; const char* b3 = b2 + kstep;
            if (last && has_next) S.a_ready(nxt);
            if constexpr (SP2) {
            PG8_LDB(B0, 0, 0); PG8_LDB(B1, 0, 1); PG8_SCHED; PG8_LDA(At, 0, 0); PG8_STAGE(PG8_SA(1, 1), a1 + hstep, voffA);
            PG8_WAIT_V(8); PG8_WAIT_L(0); PG8_BAR; PG8_MMA(0, 0, At, B0); PG8_MMA(0, 1, At, B1); PG8_BAR; PG8_SCHED;
            PG8_LDA(At, 0, 1); PG8_STAGE(PG8_SB(0, 0), b2, voffB); PG8_STAGE(PG8_SB(0, 1), b2 + hstep, voffB); PG8_STAGE(PG8_SA(0, 0), a2, voffA);
            PG8_WAIT_V(8); PG8_WAIT_L(0); PG8_BAR; PG8_MMA(1, 0, At, B0); PG8_MMA(1, 1, At, B1); PG8_BAR; PG8_SCHED;
            PG8_LDB(B0, 1, 0); PG8_LDB(B1, 1, 1); PG8_SCHED; PG8_LDA(At, 1, 0); PG8_STAGE(PG8_SA(0, 1), a2 + hstep, voffA);
            PG8_WAIT_V(8); PG8_WAIT_L(0); PG8_BAR; PG8_MMA(0, 0, At, B0); PG8_MMA(0, 1, At, B1); PG8_BAR; PG8_SCHED;
            PG8_LDA(At, 1, 1); PG8_STAGE(PG8_SB(1, 0), b3, voffB); PG8_STAGE(PG8_SB(1, 1), b3 + hstep, voffB); PG8_STAGE(PG8_SA(1, 0), a3, voffA);
            PG8_WAIT_V(8); PG8_WAIT_L(0); PG8_BAR; PG8_MMA(1, 0, At, B0); PG8_MMA(1, 1, At, B1); PG8_BAR; PG8_SCHED;
            } else {
            PG8_LDB(B0, 0, 0); PG8_SCHED; PG8_LDA(At, 0, 0); PG8_STAGE(PG8_SA(1, 1), a1 + hstep, voffA);
            PG8_WAIT_L(8); PG8_BAR; PG8_WAIT_L(0); PG8_MMA(0, 0, At, B0); PG8_BAR; PG8_SCHED;
            PG8_LDB(B1, 0, 1); PG8_STAGE(PG8_SB(0, 0), b2, voffB);
            PG8_BAR; PG8_WAIT_L(0); PG8_MMA(0, 1, At, B1); PG8_BAR;
            PG8_LDA(At, 0, 1); PG8_STAGE(PG8_SA(0, 0), a2, voffA);
            PG8_BAR; PG8_WAIT_L(0); PG8_MMA(1, 0, At, B0); PG8_BAR; PG8_SCHED;
            PG8_STAGE(PG8_SB(0, 1), b2 + hstep, voffB);
            PG8_WAIT_V(6); PG8_BAR; PG8_MMA(1, 1, At, B1); PG8_BAR;
            PG8_LDB(B0, 1, 0); PG8_SCHED; PG8_LDA(At, 1, 0); PG8_STAGE(PG8_SA(0, 1), a2 + hstep, voffA);
            PG8_WAIT_L(8); PG8_BAR; PG8_WAIT_L(0); PG8_MMA(0, 0, At, B0); PG8_BAR; PG8_SCHED;
            PG8_LDB(B1, 1, 1); PG8_STAGE(PG8_SB(1, 0), b3, voffB);
            PG8_BAR; PG8_WAIT_L(0); PG8_MMA(0, 1, At, B1); PG8_BAR;
            PG8_LDA(At, 1, 1); PG8_STAGE(PG8_SA(1, 0), a3, voffA);
            PG8_BAR; PG8_WAIT_L(0); PG8_MMA(1, 0, At, B0); PG8_BAR; PG8_SCHED;
            PG8_STAGE(PG8_SB(1, 1), b3 + hstep, voffB);
            PG8_WAIT_V(6); PG8_BAR; PG8_MMA(1, 1, At, B1); PG8_BAR;
            }
        }
        if constexpr (ALIGN_EPI) { if (wr == 0) PG8_BAR; }
        if constexpr (!Epi::AFTER_DRAIN) { E(acc, cur, wr, wc, fr, fq); S.done(cur); }
        if (!has_next) break;
#pragma unroll
        for (int a = 0; a < 2; ++a)
#pragma unroll
            for (int b = 0; b < 2; ++b)
#pragma unroll
                for (int m = 0; m < 4; ++m)
#pragma unroll
                    for (int n = 0; n < 2; ++n) acc[a][b][m][n] = (f32x4){0.f, 0.f, 0.f, 0.f};
        cur = nxt; cA = nA; cB = nB; ++ui;
        if constexpr (ALIGN_EPI) { if (wr == 1) PG8_BAR; }
    }
    PG8_WAIT_V(0);
    if constexpr (!ALIGN_EPI) { if (wr == 0) PG8_BAR; }
    PG8_BAR;
    if constexpr (Epi::AFTER_DRAIN) { E.fused(acc, cur, wr, wc, fr, fq, lds, wid, lane); S.done(cur); }
#undef PG8_SA
#undef PG8_SB
#undef PG8_STAGE
#undef PG8_LDA
#undef PG8_LDB
#undef PG8_MMA
#undef PG8_WAIT_V
#undef PG8_WAIT_L
#undef PG8_BAR
#undef PG8_SCHED
}
}

#ifndef PG8_SP2
#define PG8_SP2 true
#endif
#ifndef PG8_ALIGN
#define PG8_ALIGN true
#endif
constexpr int NWAVES = 8;
#ifndef MK_N_LAUNCHES
#define MK_N_LAUNCHES 1
#endif
constexpr int N_PHASES = 7;
constexpr int N_LAUNCHES = MK_N_LAUNCHES;

constexpr int D = 1024, FF = 4096, NIN = 1792, SEQ = 16384, NSAMP = 128, NMETA = 16;
using pg8::R_SAMPLE; using pg8::R_META; using pg8::R_PADROW; using pg8::M_PAD;
using pg8::OFF_YS; using pg8::OFF_NKP; using pg8::OFF_NVP; using pg8::OFF_NCP; using pg8::OFF_NKS; using pg8::OFF_NVS; using pg8::OFF_NCS;
constexpr float EPS = 1e-6f;

constexpr size_t MiB = 1u << 20;
constexpr size_t WS_CTL = 0, CTL_ZERO_BYTES = 1 * MiB;
constexpr size_t WS_WIN = 2 * MiB, WS_WOUT = 6 * MiB, WS_WUP = 8 * MiB, WS_WDN = 16 * MiB;
constexpr size_t WS_XREM = 24 * MiB;
constexpr size_t WS_SS2 = 25 * MiB, WS_SSF = 27 * MiB;
constexpr size_t WS_XN = 30 * MiB;
constexpr size_t WS_H = 64 * MiB;
constexpr size_t WS_Q = 64 * MiB, WS_K = 82 * MiB, WS_V = 88 * MiB, WS_U = 94 * MiB, WS_MIX = 112 * MiB;
constexpr size_t WS_END = 196 * MiB;
static_assert(WS_XN + (size_t)M_PAD * D * 2 <= WS_H && WS_H + (size_t)M_PAD * FF * 2 <= WS_END && WS_MIX + (size_t)M_PAD * D * 2 <= WS_END, "ws map");
static_assert(WS_Q + (size_t)M_PAD * 512 * 2 <= WS_K && WS_K + (size_t)M_PAD * 128 * 2 <= WS_V && WS_V + (size_t)M_PAD * 128 * 2 <= WS_U && WS_U + (size_t)M_PAD * 512 * 2 <= WS_MIX, "ws map 2");
static_assert(WS_SS2 + (size_t)M_PAD * 64 <= WS_SSF && WS_SSF + (size_t)M_PAD * 64 <= WS_XN, "ws map 3");
constexpr int CW_TMO = 0, CW_CODE = 1, CW_BAR = 4096;

constexpr int RING_OFF = 0, RING_BYTES = 131072;
constexpr int LDSCTL_OFF = RING_BYTES, MISC_OFF = LDSCTL_OFF + 320;
constexpr int LDS_BYTES = 147456;
constexpr int KS_OFF = 0, VT_OFF = 32768, VT_STRIDE = 260, BT_OFF = 32768 + 64 * VT_STRIDE * 2  , CONV_OFF = 0, SAMP_OFF = 0;
static_assert(BT_OFF % 16 == 0 && BT_OFF + 4 * 192 * 4 <= RING_BYTES, "attention LDS map");

#define GAS __attribute__((address_space(1)))
#define LAS __attribute__((address_space(3)))
typedef unsigned short bf16;
typedef unsigned v4u __attribute__((ext_vector_type(4)));
typedef float f32x4 __attribute__((ext_vector_type(4)));
typedef short bf16x8 __attribute__((ext_vector_type(8)));
typedef GAS unsigned gu32;
typedef GAS unsigned long long gu64;
#define RLX_AGENT __ATOMIC_RELAXED, __HIP_MEMORY_SCOPE_AGENT
#define LDS_WAIT() asm volatile("s_waitcnt lgkmcnt(0)" ::: "memory")
#define VM_WAIT() asm volatile("s_waitcnt vmcnt(0)" ::: "memory")
__device__ __forceinline__ unsigned long long rt() { return __builtin_amdgcn_s_memrealtime(); }
__device__ __forceinline__ unsigned f2bf(float f) { unsigned u = __builtin_bit_cast(unsigned, f); return (u + 0x7fffu + ((u >> 16) & 1u)) >> 16; }
__device__ __forceinline__ unsigned pk2(float lo, float hi) { return f2bf(lo) | (f2bf(hi) << 16); }

#define XB_TMO      128
#define XB_XCNT(j)  (256  + 64 * (j))
#define XB_XSUB(j)  (1280 + 64 * (j))
#define XB_XGEN(j)  (2304 + 64 * (j))
#define XB_TOP      3328
#define XB_TOPGEN   3392
#define XCD_BAR_WORDS 3456
#define XB_SPIN_CAP (1u << 18)

__device__ __forceinline__ unsigned xb_ld(unsigned* p)              { return __hip_atomic_load(p, __ATOMIC_RELAXED, __HIP_MEMORY_SCOPE_AGENT); }
__device__ __forceinline__ unsigned xb_add(unsigned* p, unsigned v) { return __hip_atomic_fetch_add(p, v, __ATOMIC_RELAXED, __HIP_MEMORY_SCOPE_AGENT); }
__device__ __forceinline__ unsigned xb_xcc_id() { return (unsigned)__builtin_amdgcn_s_getreg((3 << 11) | 20) & 0xFu; }
#define XB_SPIN(cond, bar) do { unsigned _sp = 0; while (cond) { __builtin_amdgcn_s_sleep(1); \
    if ((++_sp & 255u) == 0u) { if (xb_ld(&(bar)[XB_TMO])) break; if (_sp > XB_SPIN_CAP) { atomicAdd(&(bar)[XB_TMO], 1u); break; } } } } while (0)

struct XcdBarrier {
    unsigned* bar; unsigned x;
    volatile LAS unsigned* st;
};

__device__ __forceinline__ XcdBarrier xcd_barrier_post(unsigned* bar, volatile LAS unsigned* st) {
    XcdBarrier b; b.bar = bar; b.x = xb_xcc_id(); b.st = st;
    if (threadIdx.x == 0) (void)xb_add(&bar[XB_XCNT(b.x)], 1u);
    return b;
}
__device__ __forceinline__ void xcd_barrier_complete(unsigned* bar, unsigned x, unsigned& nloc, unsigned& nx) {
    const unsigned G = gridDim.x * gridDim.y * gridDim.z;
    unsigned sum, cnt, mine, sp = 0u;
    for (;;) {
        sum = 0u; cnt = 0u; mine = 0u;
#pragma unroll
        for (unsigned j = 0; j < 16; ++j) { const unsigned c = xb_ld(&bar[XB_XCNT(j)]); sum += c; cnt += (c > 0u) ? 1u : 0u; mine = (j == x) ? c : mine; }
        if (sum == G) break;
        __builtin_amdgcn_s_sleep(1);
        if ((++sp & 255u) == 0u) { if (xb_ld(&bar[XB_TMO])) break; if (sp > XB_SPIN_CAP) { atomicAdd(&bar[XB_TMO], 1u); break; } }
    }
    nloc = mine > 0u ? mine : 1u; nx = cnt > 0u ? cnt : 1u;
}

__device__ __forceinline__ void xcd_barrier(const XcdBarrier& b) {
    asm volatile("s_waitcnt vmcnt(0)" ::: "memory");
    __syncthreads();
    if (threadIdx.x == 0) {
        unsigned* bar = b.bar;
        __builtin_amdgcn_s_waitcnt(0);
        unsigned nloc = b.st[0], nx = b.st[1];
        if (nloc == 0u) { xcd_barrier_complete(bar, b.x, nloc, nx); b.st[0] = nloc; b.st[1] = nx; }
        const unsigned old = xb_add(&bar[XB_XSUB(b.x)], 1u);
        const unsigned gen = old / nloc;
        if (old + 1u == (gen + 1u) * nloc) {
            __builtin_amdgcn_fence(__ATOMIC_RELEASE, "agent");
            asm volatile("s_waitcnt vmcnt(0)" ::: "memory");
            const unsigned og = xb_add(&bar[XB_TOP], 1u);
            const unsigned tg = og / nx;
            if (og + 1u == (tg + 1u) * nx) xb_add(&bar[XB_TOPGEN], 1u);
            else XB_SPIN(xb_ld(&bar[XB_TOPGEN]) == tg, bar);
            __builtin_amdgcn_fence(__ATOMIC_ACQUIRE, "agent");
            xb_add(&bar[XB_XGEN(b.x)], 1u);
            asm volatile("s_waitcnt vmcnt(0)" ::: "memory");
        } else {
            XB_SPIN(xb_ld(&bar[XB_XGEN(b.x)]) == gen, bar);
            __builtin_amdgcn_fence(__ATOMIC_ACQUIRE, "agent");
            asm volatile("s_waitcnt vmcnt(0)" ::: "memory");
        }
    }
    __syncthreads();
}

typedef float f32x16 __attribute__((ext_vector_type(16)));
typedef short s16x4 __attribute__((ext_vector_type(4)));
typedef float f32x2_t __attribute__((ext_vector_type(2)));
typedef __bf16 bf16x2_t __attribute__((ext_vector_type(2)));
#define MFMA32(a, b, c) __builtin_amdgcn_mfma_f32_32x32x16_bf16((a), (b), (c), 0, 0, 0)
__device__ __forceinline__ unsigned cvtpk(float lo, float hi) { f32x2_t v = {lo, hi}; bf16x2_t b = __builtin_convertvector(v, bf16x2_t); return __builtin_bit_cast(unsigned, b); }
__device__ __forceinline__ float bf2f(unsigned short h) { return __builtin_bit_cast(float, (unsigned)h << 16); }

struct Frame {
    LAS unsigned char* lds;
    volatile LAS unsigned* MISC;
    gu32* ctl;
    int tid, lane, wave;
    int vcu, G;
    const float *xp, *xs, *cache_k, *cache_v, *state_conv, *meta, *rel_bias, *g1, *w_in, *sinks, *conv_w, *conv_b, *cln_g, *cln_b, *w_out, *g2, *w_up, *w_dn, *gf;
    float* out;
    bf16 *Win_t, *Wout_t, *Wup_t, *Wdn_t, *XN, *Qb, *Kb, *Vb, *Ub, *MIX, *HB;
    float *XREM, *SS2, *SSF;
};

__device__ __forceinline__ float wave_sum(float v) {
#pragma unroll
    for (int o = 1; o < 64; o <<= 1) v += __shfl_xor(v, o);
    return v;
}
__device__ __forceinline__ float wave_max(float v) {
#pragma unroll
    for (int o = 1; o < 64; o <<= 1) v = fmaxf(v, __shfl_xor(v, o));
    return v;
}

__device__ __forceinline__ void p0_transpose_item(const float* W, int K, int N, bf16* WT, const float* gain, LAS float* scr, int k0, int n0, int src_n0, int lane) {
#pragma unroll 8
    for (int i = 0; i < 32; ++i) { const int kk = 2 * i + (lane >> 5); float v = W[(size_t)(k0 + kk) * N + src_n0 + (lane & 31)]; if (gain) v *= gain[k0 + kk]; scr[kk * 33 + (lane & 31)] = v; }
    LDS_WAIT(); asm volatile("" ::: "memory");
    const int c = lane & 7;
#pragma unroll
    for (int j = 0; j < 4; ++j) { const int n = (lane >> 3) + 8 * j; const LAS float* s = scr + (8 * c) * 33 + n;
        v4u o; o.x = pk2(s[0 * 33], s[1 * 33]); o.y = pk2(s[2 * 33], s[3 * 33]); o.z = pk2(s[4 * 33], s[5 * 33]); o.w = pk2(s[6 * 33], s[7 * 33]);
        *(GAS v4u*)(WT + (size_t)(n0 + n) * K + k0 + 8 * c) = o; }
    LDS_WAIT(); asm volatile("" ::: "memory");
}
__device__ __forceinline__ int win_src_col(int n) { if (n < 768) return n; const int t = (n - 768) >> 8, j = (n - 768) & 255; return j < 128 ? 768 + 128 * t + j : 1280 + 128 * t + (j - 128); }

__device__ __forceinline__ void rms_row_to_bf16(int lane, const float* xrow, bf16* orow) {
    GAS unsigned long long* o8 = (GAS unsigned long long*)orow + lane;
    if (!xrow) {
#pragma unroll
        for (int j = 0; j < 4; ++j) o8[64 * j] = 0ull;
        return; }
    const GAS f32x4* xr = (const GAS f32x4*)xrow + lane;
    f32x4 v[4]; float s2 = 0.f;
#pragma unroll
    for (int j = 0; j < 4; ++j) { v[j] = xr[64 * j]; s2 += (v[j].x * v[j].x + v[j].y * v[j].y) + (v[j].z * v[j].z + v[j].w * v[j].w); }
    const float rs = 1.f / sqrtf(wave_sum(s2) * (1.f / D) + EPS);
#pragma unroll
    for (int j = 0; j < 4; ++j) o8[64 * j] = (unsigned long long)pk2(v[j].x * rs, v[j].y * rs) | ((unsigned long long)pk2(v[j].z * rs, v[j].w * rs) << 32);
}
__device__ __forceinline__ const float* x_row(const Frame& F, int R) {
    if (R < R_SAMPLE) return F.xp + (size_t)R * D;
    if (R < R_META) return F.xs + (size_t)(R - R_SAMPLE) * D;
    if (R < R_PADROW) return F.meta + (size_t)(R - R_META) * D;
    return nullptr;
}
__device__ __forceinline__ void p0_prologue(Frame& F) {
    LAS float* scr = (LAS float*)(F.lds + RING_OFF + F.wave * 16384);
    const int gw = F.vcu * NWAVES + F.wave, NGW = F.G * NWAVES;
    constexpr int I_IN = (D / 64) * (NIN / 32), I_OUT = (D / 64) * (D / 32), I_UP = (D / 64) * (FF / 32), I_DN = (FF / 64) * (D / 32);
    constexpr int NITEMS = I_IN + I_OUT + I_UP + I_DN;
    for (int it = gw; it < NITEMS; it += NGW) {
        int r = it;
        if (r < I_IN) { const int nb = r % (NIN / 32), kb = r / (NIN / 32); p0_transpose_item(F.w_in, D, NIN, F.Win_t, F.g1, scr, 64 * kb, 32 * nb, win_src_col(32 * nb), F.lane); continue; } r -= I_IN;
        if (r < I_OUT) { const int nb = r % (D / 32), kb = r / (D / 32); p0_transpose_item(F.w_out, D, D, F.Wout_t, nullptr, scr, 64 * kb, 32 * nb, 32 * nb, F.lane); continue; } r -= I_OUT;
        if (r < I_UP) { const int nb = r % (FF / 32), kb = r / (FF / 32); p0_transpose_item(F.w_up, D, FF, F.Wup_t, F.g2, scr, 64 * kb, 32 * nb, 32 * nb, F.lane); continue; } r -= I_UP;
        { const int nb = r % (D / 32), kb = r / (D / 32); p0_transpose_item(F.w_dn, FF, D, F.Wdn_t, nullptr, scr, 64 * kb, 32 * nb, 32 * nb, F.lane); }
    }
    for (int R = gw; R < M_PAD; R += NGW) rms_row_to_bf16(F.lane, x_row(F, R), F.XN + (size_t)R * D);
    const int gt = F.vcu * (NWAVES * 64) + F.tid, NGT = F.G * NWAVES * 64;
    for (int i = gt; i < 128 * D / 4; i += NGT) { const int row = i / (D / 4); f32x4 v = {0.f, 0.f, 0.f, 0.f}; if (row < NMETA) v = ((const GAS f32x4*)F.meta)[i]; ((GAS f32x4*)F.XREM)[i] = v; }
    for (int i = gt; i < (M_PAD - R_PADROW) * D / 8; i += NGT) ((GAS v4u*)(F.MIX + (size_t)R_PADROW * D))[i] = (v4u){0u, 0u, 0u, 0u};
    for (int i = gt; i < NSAMP * 127 * 32; i += NGT) { const int s = i / (127 * 32), r = i % (127 * 32);
        ((GAS f32x4*)(F.out + OFF_NKS))[(size_t)s * 4096 + r] = ((const GAS f32x4*)F.cache_k)[(size_t)s * 4096 + 32 + r];
        ((GAS f32x4*)(F.out + OFF_NVS))[(size_t)s * 4096 + r] = ((const GAS f32x4*)F.cache_v)[(size_t)s * 4096 + 32 + r]; }
    for (int i = gt; i < NSAMP * 29 * 128; i += NGT) { const int s = i / (29 * 128), r = i % (29 * 128);
        ((GAS f32x4*)(F.out + OFF_NCS))[(size_t)s * 3840 + r] = ((const GAS f32x4*)F.state_conv)[(size_t)s * 3840 + 128 + r]; }
}

__device__ __forceinline__ int row_of_pos(int p) { return p >= 128 ? p - 128 : (p >= 112 ? R_META + (p - 112) : R_PADROW); }
__device__ __forceinline__ int crow(int r, int hi) { return (r & 3) + 8 * (r >> 2) + 4 * hi; }
__device__ __forceinline__ int t5_bucket(int d) { if (d < 16) return d; const int l = 16 + (int)(logf((float)d * 0.0625f) / 2.0794415416798357f * 16.0f); return l < 31 ? l : 31; }

__device__ __forceinline__ void attn_unit(Frame& F, int b, int hk) {
    LAS unsigned char* lds = F.lds;
    int tid = F.tid; asm volatile("" : "+v"(tid));
    const int lane = tid & 63, w = __builtin_amdgcn_readfirstlane(tid >> 6);
    const int p0 = 128 * (b - 1);
    LAS unsigned short* vt = (LAS unsigned short*)(lds + VT_OFF);
#pragma unroll
    for (int i = 0; i < 4; ++i) {
        const int cid = tid + 512 * i, row = cid >> 3, ch = cid & 7;
        const size_t R = (size_t)row_of_pos(p0 + row);
        const v4u kv = *(const GAS v4u*)(F.Kb + R * 128 + hk * 64 + ch * 8);
        const v4u vv = *(const GAS v4u*)(F.Vb + R * 128 + hk * 64 + ch * 8);
        *(LAS v4u*)(lds + KS_OFF + row * 128 + ((ch ^ (row & 7)) << 4)) = kv;
#pragma unroll
        for (int e = 0; e < 8; ++e) vt[(ch * 8 + e) * VT_STRIDE + row] = (unsigned short)((vv[e >> 1] >> (16 * (e & 1))) & 0xffffu);
    }
    LAS float* btab = (LAS float*)(lds + BT_OFF);
    for (int i = tid; i < 4 * 192; i += 512) { const int g = i / 192, dist = (i % 192) - 32; float v = -INFINITY;
        if (dist >= 0 && dist <= 128) v = F.rel_bias[t5_bucket(dist) * 8 + 4 * hk + g];
        btab[i] = v; }
    __syncthreads();
    const int g = w >> 1, qh = w & 1, hq = 4 * hk + g, ql = lane & 31, hi = lane >> 5;
    const float sink = F.sinks[hq];
    const LAS float* bt = btab + g * 192;
#pragma unroll 1
    for (int qg = 0; qg < 2; ++qg) {
        const int Q0 = 64 * qh + 32 * qg;
        const size_t Rq = (size_t)row_of_pos(128 * b + Q0 + ql);
        bf16x8 qf[4];
#pragma unroll
        for (int ks = 0; ks < 4; ++ks) qf[ks] = *(const GAS bf16x8*)(F.Qb + Rq * 512 + hq * 64 + ks * 16 + 8 * hi);
        f32x16 S[5];
#pragma unroll
        for (int t = 0; t < 5; ++t) {
#pragma unroll
            for (int r = 0; r < 16; ++r) S[t][r] = 0.f;
            const int krow = Q0 + 32 * t + ql;
#pragma unroll
            for (int ks = 0; ks < 4; ++ks) { const bf16x8 kf = *(const LAS bf16x8*)(lds + KS_OFF + krow * 128 + (((ks * 2 + hi) ^ (krow & 7)) << 4)); S[t] = MFMA32(kf, qf[ks], S[t]); }
        }
        float mx = sink;
#pragma unroll
        for (int t = 0; t < 5; ++t)
#pragma unroll
            for (int r = 0; r < 16; ++r) {
                const int idx = 160 - 32 * t + ql - 4 * hi - (r & 3) - 8 * (r >> 2);
                float s = S[t][r] + bt[idx];
                if (b <= 1) { const int kp = p0 + Q0 + 32 * t + crow(r, hi); if (kp < 112) s = -INFINITY; }
                S[t][r] = s; mx = fmaxf(mx, s); }
        mx = fmaxf(mx, __shfl_xor(mx, 32));
        float sum = 0.f;
#pragma unroll
        for (int t = 0; t < 5; ++t)
#pragma unroll
            for (int r = 0; r < 16; ++r) { const float p = __expf(S[t][r] - mx); S[t][r] = p; sum += p; }
        sum += __shfl_xor(sum, 32);
        const float inv = 1.0f / (sum + __expf(sink - mx));
        f32x16 O[2];
#pragma unroll
        for (int r = 0; r < 16; ++r) { O[0][r] = 0.f; O[1][r] = 0.f; }
#pragma unroll
        for (int t = 0; t < 5; ++t)
#pragma unroll
            for (int s2 = 0; s2 < 2; ++s2) {
                v4u pw; pw.x = cvtpk(S[t][8 * s2 + 0], S[t][8 * s2 + 1]); pw.y = cvtpk(S[t][8 * s2 + 2], S[t][8 * s2 + 3]); pw.z = cvtpk(S[t][8 * s2 + 4], S[t][8 * s2 + 5]); pw.w = cvtpk(S[t][8 * s2 + 6], S[t][8 * s2 + 7]);
                const bf16x8 pf = __builtin_bit_cast(bf16x8, pw);
                const int kb = Q0 + 32 * t + 16 * s2 + 4 * hi;
#pragma unroll
                for (int dt = 0; dt < 2; ++dt) {
                    const LAS unsigned char* ap = lds + VT_OFF + ((32 * dt + ql) * VT_STRIDE + kb) * 2;
                    const s16x4 lo = *(const LAS s16x4*)ap, hi4 = *(const LAS s16x4*)(ap + 16);
                    const bf16x8 af = __builtin_shufflevector(lo, hi4, 0, 1, 2, 3, 4, 5, 6, 7);
                    O[dt] = MFMA32(af, pf, O[dt]); }
            }
        if (b > 0 || Q0 + ql >= 112) {
            bf16* orow = F.MIX + Rq * 1024 + hq * 64 + 4 * hi;
#pragma unroll
            for (int dt = 0; dt < 2; ++dt)
#pragma unroll
                for (int gq = 0; gq < 4; ++gq) {
                    unsigned long long wv = (unsigned long long)cvtpk(O[dt][4 * gq] * inv, O[dt][4 * gq + 1] * inv) | ((unsigned long long)cvtpk(O[dt][4 * gq + 2] * inv, O[dt][4 * gq + 3] * inv) << 32);
                    *(GAS unsigned long long*)(orow + 32 * dt + 8 * gq) = wv; }
        }
    }
    __syncthreads();
}

__device__ __forceinline__ void sample_attn(Frame& F, int s) {
    const int hq = F.wave, hk = hq >> 2, lane = F.lane;
    LAS float* qs = (LAS float*)(F.lds + SAMP_OFF + hq * 1024);
    LAS float* ps = qs + 64;
    qs[lane] = bf2f(F.Qb[(size_t)(R_SAMPLE + s) * 512 + hq * 64 + lane]);
    LDS_WAIT();
    const float* ck = F.cache_k + ((size_t)s * 128 * 2 + hk) * 64;
    const float* k1 = ck + (size_t)lane * 128; const float* k2 = ck + (size_t)(lane + 64) * 128;
    const float* kn = F.out + OFF_NKS + ((size_t)s * 128 + 127) * 128 + hk * 64;
    const float* vn = F.out + OFF_NVS + ((size_t)s * 128 + 127) * 128 + hk * 64;
    float d1 = 0.f, d2 = 0.f, d0 = 0.f;
#pragma unroll 4
    for (int i = 0; i < 16; ++i) { const f32x4 q4 = *(const LAS f32x4*)(qs + 4 * i);
        const f32x4 a = *(const GAS f32x4*)(k1 + 4 * i), bq = *(const GAS f32x4*)(k2 + 4 * i);
        d1 += (a[0] * q4[0] + a[1] * q4[1]) + (a[2] * q4[2] + a[3] * q4[3]);
        d2 += (bq[0] * q4[0] + bq[1] * q4[1]) + (bq[2] * q4[2] + bq[3] * q4[3]); }
    d0 = wave_sum(kn[lane] * qs[lane]);
    const float sink = F.sinks[hq];
    const float s1 = d1 + F.rel_bias[t5_bucket(128 - lane) * 8 + hq], s2 = d2 + F.rel_bias[t5_bucket(64 - lane) * 8 + hq], s0 = d0 + F.rel_bias[hq];
    const float mx = fmaxf(fmaxf(sink, s0), wave_max(fmaxf(s1, s2)));
    const float p1 = __expf(s1 - mx), p2 = __expf(s2 - mx), p0 = __expf(s0 - mx);
    ps[lane] = p1; ps[64 + lane] = p2;
    const float den = wave_sum(p1 + p2) + p0 + __expf(sink - mx);
    LDS_WAIT();
    const float* cv = F.cache_v + ((size_t)s * 128 * 2 + hk) * 64 + lane;
    float o = p0 * vn[lane];
#pragma unroll 8
    for (int wk = 0; wk < 128; ++wk) o += ps[wk] * cv[(size_t)wk * 128];
    F.MIX[(size_t)(R_SAMPLE + s) * 1024 + hq * 64 + lane] = (bf16)f2bf(o / den);
}

__device__ __forceinline__ float load_u(const Frame& F, int e, int c) { if (e < 0) return 0.f; const size_t R = e < NMETA ? (size_t)(R_META + e) : (size_t)(e - NMETA); return bf2f(F.Ub[R * 512 + c]); }
__device__ __forceinline__ void ln_swish_token(const Frame& F, const LAS float* crow_, size_t R, const f32x4& g0, const f32x4& g1, const f32x4& b0, const f32x4& b1) {
    const int lane = F.lane;
    f32x4 v0 = *(const LAS f32x4*)(crow_ + lane * 8), v1 = *(const LAS f32x4*)(crow_ + lane * 8 + 4);
    const float mean = wave_sum((v0[0] + v0[1]) + (v0[2] + v0[3]) + (v1[0] + v1[1]) + (v1[2] + v1[3])) * (1.0f / 512.0f);
    v0 = v0 - mean; v1 = v1 - mean;
    const float var = wave_sum((v0[0] * v0[0] + v0[1] * v0[1]) + (v0[2] * v0[2] + v0[3] * v0[3]) + (v1[0] * v1[0] + v1[1] * v1[1]) + (v1[2] * v1[2] + v1[3] * v1[3])) * (1.0f / 512.0f);
    const float rstd = 1.0f / sqrtf(var + EPS);
    f32x4 y0 = v0 * rstd * g0 + b0, y1 = v1 * rstd * g1 + b1;
#pragma unroll
    for (int i = 0; i < 4; ++i) { y0[i] = y0[i] * __builtin_amdgcn_rcpf(1.0f + __expf(-y0[i])); y1[i] = y1[i] * __builtin_amdgcn_rcpf(1.0f + __expf(-y1[i])); }
    v4u o; o.x = cvtpk(y0[0], y0[1]); o.y = cvtpk(y0[2], y0[3]); o.z = cvtpk(y1[0], y1[1]); o.w = cvtpk(y1[2], y1[3]);
    *(GAS v4u*)(F.MIX + R * 1024 + 512 + lane * 8) = o;
}
__device__ __forceinline__ void conv_tile(Frame& F, int e0, int nchunks) {
    const int c = F.tid, lane = F.lane, w = F.wave;
    LAS float* cbuf = (LAS float*)(F.lds + CONV_OFF);
    float wv[31];
#pragma unroll
    for (int j = 0; j < 31; ++j) wv[j] = F.conv_w[j * 512 + c];
    const float cb = F.conv_b[c];
    const f32x4 g0 = *(const GAS f32x4*)(F.cln_g + lane * 8), g1 = *(const GAS f32x4*)(F.cln_g + lane * 8 + 4), b0 = *(const GAS f32x4*)(F.cln_b + lane * 8), b1 = *(const GAS f32x4*)(F.cln_b + lane * 8 + 4);
    float h[46];
#pragma unroll
    for (int k = 0; k < 30; ++k) h[k] = load_u(F, e0 - 30 + k, c);
#pragma unroll 1
    for (int ch = 0; ch < nchunks; ++ch) {
        const int eb = e0 + 16 * ch;
#pragma unroll
        for (int k = 0; k < 16; ++k) h[30 + k] = load_u(F, eb + k, c);
#pragma unroll
        for (int t = 0; t < 16; ++t) { float o = cb;
#pragma unroll
            for (int j = 0; j < 31; ++j) o += wv[j] * h[t + j];
            cbuf[t * 512 + c] = o; }
        __syncthreads();
#pragma unroll
        for (int tt = 0; tt < 2; ++tt) { const int t = 2 * w + tt, e = eb + t; const size_t R = e < NMETA ? (size_t)(R_META + e) : (size_t)(e - NMETA);
            ln_swish_token(F, cbuf + t * 512, R, g0, g1, b0, b1); }
        __syncthreads();
#pragma unroll
        for (int k = 0; k < 30; ++k) h[k] = h[k + 16];
    }
}
__device__ __forceinline__ void sample_conv(Frame& F, int s) {
    const int c = F.tid, lane = F.lane;
    LAS float* cbuf = (LAS float*)(F.lds + CONV_OFF);
    float acc = F.conv_b[c];
    const float* st = F.state_conv + (size_t)s * 30 * 512 + c;
#pragma unroll 6
    for (int j = 0; j < 30; ++j) acc += F.conv_w[j * 512 + c] * st[(size_t)j * 512];
    acc += F.conv_w[30 * 512 + c] * F.out[OFF_NCS + ((size_t)s * 30 + 29) * 512 + c];
    cbuf[c] = acc;
    __syncthreads();
    if (F.wave == 0) {
        const f32x4 g0 = *(const GAS f32x4*)(F.cln_g + lane * 8), g1 = *(const GAS f32x4*)(F.cln_g + lane * 8 + 4), b0 = *(const GAS f32x4*)(F.cln_b + lane * 8), b1 = *(const GAS f32x4*)(F.cln_b + lane * 8 + 4);
        ln_swish_token(F, cbuf, (size_t)(R_SAMPLE + s), g0, g1, b0, b1);
    }
    __syncthreads();
}

__device__ __forceinline__ void p2_mixers(Frame& F) {
    const int bx = (int)blockIdx.x;
    for (int u = bx; u < 258; u += F.G) { if (u < 256) attn_unit(F, 1 + (u >> 1), u & 1); else attn_unit(F, 0, u - 256); }
    for (int u = bx; u < 257; u += F.G) { if (u < 256) conv_tile(F, NMETA + 64 * u, 4); else conv_tile(F, 0, 1); }
    for (int u = F.G - 1 - bx; u < 256; u += F.G) { if (u < 128) { sample_attn(F, u); __syncthreads(); } else sample_conv(F, u - 128); }
}

__device__ __forceinline__ void p6_final_norm(Frame& F) {
    const int gw = F.vcu * NWAVES + F.wave, NGW = F.G * NWAVES, lane = F.lane;
    f32x4 gv[4];
#pragma unroll
    for (int j = 0; j < 4; ++j) gv[j] = ((const GAS f32x4*)F.gf)[lane + 64 * j];
    for (int R = gw; R < R_META; R += NGW) {
        GAS f32x4* row = (GAS f32x4*)(F.out + (size_t)R * D) + lane;
        f32x4 v[4];
#pragma unroll
        for (int j = 0; j < 4; ++j) v[j] = row[64 * j];
        const float s = wave_sum(lane < 16 ? F.SSF[(size_t)R * 16 + lane] : 0.f);
        const float rs = 1.0f / sqrtf(s * (1.0f / D) + EPS);
#pragma unroll
        for (int j = 0; j < 4; ++j) row[64 * j] = v[j] * rs * gv[j];
    }
}

struct Args { const float* in[19]; float* out; unsigned char* ws; int ph_lo, ph_hi, li, pad; };
__global__ void __launch_bounds__(NWAVES * 64, 2) hymba_fwd(Args args) {
    extern __shared__ __attribute__((aligned(16))) unsigned char lds[];
    Frame F;
    F.lds = (LAS unsigned char*)lds;
    F.MISC = (volatile LAS unsigned*)(F.lds + MISC_OFF);
    F.tid = threadIdx.x; F.lane = F.tid & 63; F.wave = __builtin_amdgcn_readfirstlane(F.tid >> 6);
    F.G = gridDim.x; { const int bx = blockIdx.x; F.vcu = (F.G % 8 == 0) ? (bx % 8) * (F.G / 8) + bx / 8 : bx; }
    unsigned char* ws = args.ws;
    F.ctl = (gu32*)(ws + WS_CTL);
    F.xp = args.in[0]; F.xs = args.in[1]; F.cache_k = args.in[2]; F.cache_v = args.in[3]; F.state_conv = args.in[4]; F.meta = args.in[5]; F.rel_bias = args.in[6];
    F.g1 = args.in[7]; F.w_in = args.in[8]; F.sinks = args.in[9]; F.conv_w = args.in[10]; F.conv_b = args.in[11]; F.cln_g = args.in[12]; F.cln_b = args.in[13];
    F.w_out = args.in[14]; F.g2 = args.in[15]; F.w_up = args.in[16]; F.w_dn = args.in[17]; F.gf = args.in[18]; F.out = args.out;
    F.Win_t = (bf16*)(ws + WS_WIN); F.Wout_t = (bf16*)(ws + WS_WOUT); F.Wup_t = (bf16*)(ws + WS_WUP); F.Wdn_t = (bf16*)(ws + WS_WDN);
    F.XN = (bf16*)(ws + WS_XN); F.Qb = (bf16*)(ws + WS_Q); F.Kb = (bf16*)(ws + WS_K); F.Vb = (bf16*)(ws + WS_V); F.Ub = (bf16*)(ws + WS_U); F.MIX = (bf16*)(ws + WS_MIX); F.HB = (bf16*)(ws + WS_H);
    F.XREM = (float*)(ws + WS_XREM); F.SS2 = (float*)(ws + WS_SS2); F.SSF = (float*)(ws + WS_SSF);
    for (int u = F.tid; u < (LDS_BYTES - LDSCTL_OFF) / 4; u += NWAVES * 64) ((LAS unsigned*)(F.lds + LDSCTL_OFF))[u] = 0u;
    __syncthreads();
    XcdBarrier bar; bar.bar = (unsigned*)(F.ctl + CW_BAR); bar.x = 0; bar.st = nullptr;
    if (N_LAUNCHES == 1) bar = xcd_barrier_post((unsigned*)(F.ctl + CW_BAR), F.MISC + 8);
#define GRID_BAR(seam) do { if (N_LAUNCHES != 1) { if (F.tid == 0) __hip_atomic_store(F.ctl + CW_TMO, 0xBADBA0u | (unsigned)(seam), RLX_AGENT); } else { xcd_barrier(bar); } } while (0)
    const int lo = args.ph_lo, hi = args.ph_hi;
#define IN(k) (lo <= (k) && (k) < hi)
#define BOTH(k) (IN(k) && IN((k) + 1))
    const pg8::ResPtrs RP{F.xp, F.xs, F.XREM, F.out};

    if (IN(0)) { p0_prologue(F); if (BOTH(0)) GRID_BAR(0); }

    if (IN(1)) {
        pg8::Gemm g{F.XN, F.Win_t, M_PAD, NIN, D}; pg8::StaticOrder S; S.init(M_PAD, NIN, F.G, (int)blockIdx.x);
        pg8::EpiQKV E{F.Qb, F.Kb, F.Vb, F.Ub, F.out};
        pg8::gemm_phase<pg8::EpiQKV, pg8::StaticOrder, PG8_ALIGN, PG8_SP2>(F.lds + RING_OFF, g, S, E);
        if (BOTH(1)) GRID_BAR(1);
    }

    if (IN(2)) { p2_mixers(F); if (BOTH(2)) GRID_BAR(2); }

    if (IN(3)) {
        pg8::Gemm g{F.MIX, F.Wout_t, M_PAD, D, D}; pg8::StaticOrder S; S.init(M_PAD, D, F.G, (int)blockIdx.x);
        pg8::EpiWo E{RP, F.XN, F.SS2};
        pg8::gemm_phase<pg8::EpiWo, pg8::StaticOrder, PG8_ALIGN, PG8_SP2>(F.lds + RING_OFF, g, S, E);
        if (BOTH(3)) GRID_BAR(3);
    }

    if (IN(4)) {
        pg8::Gemm g{F.XN, F.Wup_t, M_PAD, FF, D}; pg8::StaticOrder S; S.init(M_PAD, FF, F.G, (int)blockIdx.x);
        pg8::EpiUp E{F.HB, F.SS2, EPS};
        pg8::gemm_phase<pg8::EpiUp, pg8::StaticOrder, PG8_ALIGN, PG8_SP2>(F.lds + RING_OFF, g, S, E);
        if (BOTH(4)) GRID_BAR(4);
    }

    if (IN(5)) {
        pg8::Gemm g{F.HB, F.Wdn_t, M_PAD, D, FF}; pg8::StaticOrder S; S.init(M_PAD, D, F.G, (int)blockIdx.x);
        pg8::EpiDown E{RP, F.SSF};
        pg8::gemm_phase<pg8::EpiDown, pg8::StaticOrder, PG8_ALIGN, PG8_SP2>(F.lds + RING_OFF, g, S, E);
        if (BOTH(5)) GRID_BAR(5);
    }

    if (IN(6)) { p6_final_norm(F); }
#undef IN
#undef BOTH
}

extern "C" void kernel_launch(void* const* d_in, const int* in_sizes, int n_in, void* d_out, int out_size, void* d_ws, size_t ws_size, hipStream_t stream) {
    static int grid = 0;
    if (grid == 0) {
        if (n_in != 19 || ws_size < WS_END) { fprintf(stderr, "kernel_launch: built for 19 inputs and >= %zu bytes of workspace; got n_in %d, ws %zu; nothing launched\n", (size_t)WS_END, n_in, ws_size); grid = -1; return; }
        int dev = 0, cus = 0, per_cu = 0;
        if (hipGetDevice(&dev) != hipSuccess || hipDeviceGetAttribute(&cus, hipDeviceAttributeMultiprocessorCount, dev) != hipSuccess) { fprintf(stderr, "kernel_launch: device query failed\n"); grid = -1; return; }
        if (hipFuncSetAttribute((const void*)hymba_fwd, hipFuncAttributeMaxDynamicSharedMemorySize, LDS_BYTES) != hipSuccess) { fprintf(stderr, "kernel_launch: hipFuncSetAttribute failed\n"); grid = -1; return; }
        if (hipOccupancyMaxActiveBlocksPerMultiprocessor(&per_cu, (const void*)hymba_fwd, NWAVES * 64, LDS_BYTES) != hipSuccess || per_cu < 1) { fprintf(stderr, "kernel_launch: occupancy query reports %d workgroups per CU\n", per_cu); per_cu = 1; }
        (void)hipGetLastError();
        grid = cus;
        if (grid > 256) grid = 256;
    }
    if (grid < 0) return;
    if (hipMemsetAsync((char*)d_ws + WS_CTL, 0, CTL_ZERO_BYTES, stream) != hipSuccess) { fprintf(stderr, "kernel_launch: hipMemsetAsync failed\n"); return; }
    Args a{};
    for (int i = 0; i < 19; ++i) a.in[i] = (const float*)d_in[i];
    a.out = (float*)d_out; a.ws = (unsigned char*)d_ws;
    for (int li = 0; li < N_LAUNCHES; ++li) {
        a.ph_lo = (N_LAUNCHES == 1) ? 0 : li; a.ph_hi = (N_LAUNCHES == 1) ? N_PHASES : li + 1; a.li = li;
        hipLaunchKernelGGL(hymba_fwd, dim3(grid), dim3(NWAVES * 64), LDS_BYTES, stream, a);
        const hipError_t le = hipPeekAtLastError();
        if (le != hipSuccess) { fprintf(stderr, "kernel_launch: launch %d failed: %s\n", li, hipGetErrorName(le)); break; }
    }
}
```
